# Optimizing an MI355X kernel written in HIP

```python
import jax, jax.numpy as jnp
from jax import lax
import numpy as np

D_MODEL = 2048
BATCH = 4
SEQ = 4096
DEPTH = 2

GRID_W = 64
CTX_LEN = 256
N_MIXERS = 2
N_GLA_LAYERS = (DEPTH + N_MIXERS - 1) // N_MIXERS
N_NAT_LAYERS = DEPTH // N_MIXERS

GLA_HEADS = 4
GLA_DK = D_MODEL // (2 * GLA_HEADS)
GLA_DV = D_MODEL // GLA_HEADS
GLA_CHUNK = 64
GLA_GATE_RANK = 16
GLA_GATE_NORM = 16.0
GLA_QK = GLA_HEADS * GLA_DK
GLA_VD = GLA_HEADS * GLA_DV
GLA_IN = 2 * GLA_QK + 2 * GLA_VD + 2 * GLA_GATE_RANK
ROPE_BASE = 10000.0

NAT_HEADS = 16
NAT_DH = D_MODEL // NAT_HEADS
WIN_R = 8
WIN_C = 16
NAT_QC = 16

N_GROUPS = 4
EXPERTS_PER_GROUP = 4
N_EXPERTS = N_GROUPS * EXPERTS_PER_GROUP
TOP_K_IN_GROUP = 2
D_EXPERT = D_MODEL // 2
MOE_BLOCK = 256

DEEPNORM_ALPHA = (2 * DEPTH) ** 0.25
DEEPNORM_BETA = (8 * DEPTH) ** -0.25
LN_EPS = 1e-5
NEG_INF = -1e30

kernel_name = "hybrid_gla_natten_hmoe_dit"


def _layer_norm(x, g, b):
    xf = x.astype(jnp.float32)
    mu = jnp.mean(xf, axis=-1, keepdims=True)
    var = jnp.mean(jnp.square(xf - mu), axis=-1, keepdims=True)
    return ((xf - mu) * lax.rsqrt(var + LN_EPS) * g + b).astype(x.dtype)


def _rope_axis(x, pos):
    half = x.shape[-1] // 2
    freqs = ROPE_BASE ** (-jnp.arange(half, dtype=jnp.float32) / half)
    ang = pos.astype(jnp.float32)[:, None] * freqs
    cos, sin = jnp.cos(ang), jnp.sin(ang)
    x1, x2 = x[..., :half], x[..., half:]
    return jnp.concatenate([x1 * cos - x2 * sin, x1 * sin + x2 * cos], axis=-1)


def _rope_2d(x):
    t = jnp.arange(x.shape[-2])
    d_ax = x.shape[-1] // 2
    return jnp.concatenate([_rope_axis(x[..., :d_ax], t // GRID_W),
                            _rope_axis(x[..., d_ax:], t % GRID_W)], axis=-1)


def _gla_chunked(q, k, v, g, s0):
    b_, h_, n, _ = q.shape
    dv = v.shape[-1]
    nc = n // GLA_CHUNK
    ch = lambda t: t.reshape(b_, h_, nc, GLA_CHUNK, t.shape[-1])
    q, k, v, g = ch(q), ch(k), ch(v), ch(g)
    cum = jnp.cumsum(g, axis=3)
    total = cum[:, :, :, -1]
    q_dec = q * jnp.exp(cum)
    k_inv = k * jnp.exp(-cum)
    k_end = k * jnp.exp(total[:, :, :, None] - cum)
    tri = jnp.tril(jnp.ones((GLA_CHUNK, GLA_CHUNK), dtype=bool))
    att = jnp.where(tri, jnp.einsum('bhncd,bhnsd->bhncs', q_dec, k_inv), 0.0)
    o_intra = jnp.einsum('bhncs,bhnsv->bhncv', att, v)

    def step(state, xs):
        q_c, k_c, v_c, d_c = xs
        o_c = jnp.einsum('bhcd,bhdv->bhcv', q_c, state)
        state = state * d_c[..., None] + jnp.einsum('bhcd,bhcv->bhdv', k_c, v_c)
        return state, o_c

    xs = (jnp.moveaxis(q_dec, 2, 0), jnp.moveaxis(k_end, 2, 0), jnp.moveaxis(v, 2, 0),
          jnp.moveaxis(jnp.exp(total), 2, 0))
    s_fin, o_inter = lax.scan(step, s0, xs)
    o = o_intra + jnp.moveaxis(o_inter, 0, 2)
    return o.reshape(b_, h_, n, dv), s_fin


def _gla_mixer(h_lat, h_ctx, w_in, w_gate, b_gate, norm_g, w_out):
    def project(h):
        bsz, n, _ = h.shape
        p = h @ w_in
        q, k, v, r, glr = jnp.split(p, [GLA_QK, 2 * GLA_QK, 2 * GLA_QK + GLA_VD, 2 * GLA_QK + 2 * GLA_VD], axis=-1)
        heads = lambda t, d: t.reshape(bsz, n, GLA_HEADS, d).transpose(0, 2, 1, 3).astype(jnp.float32)
        glr = glr.reshape(bsz, n, 2, GLA_GATE_RANK)
        z = jnp.einsum('bndr,drk->bndk', glr, w_gate) + b_gate
        logdecay = jax.nn.log_sigmoid(z.astype(jnp.float32)) / GLA_GATE_NORM
        return (heads(q, GLA_DK) * GLA_DK ** -0.5, heads(k, GLA_DK), heads(v, GLA_DV), r,
                heads(logdecay[:, :, 0], GLA_DK), heads(logdecay[:, :, 1], GLA_DK))

    ql, kl, vl, rl, gfl, gbl = project(h_lat)
    ql, kl = _rope_2d(ql), _rope_2d(kl)
    qc, kc, vc, rc, gfc, gbc = project(h_ctx)
    bsz = h_lat.shape[0]
    s0 = jnp.zeros((bsz, GLA_HEADS, GLA_DK, GLA_DV), jnp.float32)
    flip = lambda t: jnp.flip(t, axis=2)
    o_cf, s_f = _gla_chunked(qc, kc, vc, gfc, s0)
    o_lf, _ = _gla_chunked(ql, kl, vl, gfl, s_f)
    o_cb, s_b = _gla_chunked(flip(qc), flip(kc), flip(vc), flip(gbc), s0)
    o_lb, _ = _gla_chunked(flip(ql), flip(kl), flip(vl), flip(gbl), s_b)

    def finish(o, r):
        o = o * lax.rsqrt(jnp.mean(jnp.square(o), axis=-1, keepdims=True) + LN_EPS) * norm_g
        b_, _, n, _ = o.shape
        o = o.transpose(0, 2, 1, 3).reshape(b_, n, GLA_VD).astype(r.dtype)
        return (o * jax.nn.silu(r)) @ w_out

    return finish(o_lf + flip(o_lb), rl), finish(o_cf + flip(o_cb), rc)


def _natten_layout(rows):
    kr = min(WIN_R, rows)
    qr = max(d for d in (8, 4, 2, 1) if rows % d == 0)
    krb = min(qr + kr - 1, rows)
    kcb = min(NAT_QC + WIN_C - 1, GRID_W)
    n_rb, n_cb = rows // qr, GRID_W // NAT_QC
    rs = np.clip(np.arange(rows) - kr // 2, 0, rows - kr)
    cs = np.clip(np.arange(GRID_W) - WIN_C // 2, 0, GRID_W - WIN_C)
    r0 = np.clip(rs[np.arange(n_rb) * qr], 0, rows - krb)
    c0 = np.clip(cs[np.arange(n_cb) * NAT_QC], 0, GRID_W - kcb)
    q_r = (np.arange(n_rb)[:, None] * qr + np.arange(qr))[:, None, :, None, None, None]
    q_c = (np.arange(n_cb)[:, None] * NAT_QC + np.arange(NAT_QC))[None, :, None, :, None, None]
    k_r = (r0[:, None] + np.arange(krb))[:, None, None, None, :, None]
    k_c_all = c0[:, None] + np.arange(kcb)
    k_c = k_c_all[None, :, None, None, None, :]
    shape = (n_rb, n_cb, qr, NAT_QC, krb, kcb)
    mask = (k_r >= rs[q_r]) & (k_r < rs[q_r] + kr) & (k_c >= cs[q_c]) & (k_c < cs[q_c] + WIN_C)
    dr = np.clip(k_r - q_r + WIN_R - 1, 0, 2 * WIN_R - 2)
    dc = np.clip(k_c - q_c + WIN_C - 1, 0, 2 * WIN_C - 2)
    flat = lambda a: np.broadcast_to(a, shape).reshape(n_rb, n_cb, qr * NAT_QC, krb * kcb)
    return (qr, krb, kcb, r0.astype(np.int32), k_c_all.astype(np.int32),
            flat(mask), flat(dr).astype(np.int32), flat(dc).astype(np.int32))


def _natten_mixer(h_lat, h_ctx, w_in, rpb, w_out, with_ctx_out):
    bsz, n, d = h_lat.shape
    rows = n // GRID_W
    qr, krb, kcb, r0, k_cols, mask, dr, dc = _natten_layout(rows)
    n_rb, n_cb = rows // qr, GRID_W // NAT_QC
    scale = NAT_DH ** -0.5

    def heads(h):
        p = (h @ w_in).reshape(h.shape[0], h.shape[1], 3, NAT_HEADS, NAT_DH).transpose(2, 0, 3, 1, 4)
        return p[0], p[1], p[2]

    ql, kl, vl = heads(h_lat)
    qc, kc, vc = heads(h_ctx)
    k_grid = kl.reshape(bsz, NAT_HEADS, rows, GRID_W, NAT_DH)
    v_grid = vl.reshape(bsz, NAT_HEADS, rows, GRID_W, NAT_DH)
    q_blk = ql.reshape(bsz, NAT_HEADS, n_rb, qr, n_cb, NAT_QC, NAT_DH).transpose(2, 0, 1, 4, 3, 5, 6)
    q_blk = q_blk.reshape(n_rb, bsz, NAT_HEADS, n_cb, qr * NAT_QC, NAT_DH)
    col_idx = jnp.asarray(k_cols)
    kloc = krb * kcb

    def band(t_rows):
        t = t_rows[:, :, :, col_idx]
        return t.transpose(0, 1, 3, 2, 4, 5).reshape(bsz, NAT_HEADS, n_cb, kloc, NAT_DH)

    def row_block(xs):
        q_b, r_start, m_b, dr_b, dc_b = xs
        k_b = band(lax.dynamic_slice_in_dim(k_grid, r_start, krb, axis=2))
        v_b = band(lax.dynamic_slice_in_dim(v_grid, r_start, krb, axis=2))
        bias = rpb[:, dr_b, dc_b].astype(jnp.float32)
        s_loc = jnp.einsum('bhnqd,bhnkd->bhnqk', q_b, k_b).astype(jnp.float32) * scale + bias
        s_loc = jnp.where(m_b, s_loc, NEG_INF)
        s_ctx = jnp.einsum('bhnqd,bhkd->bhnqk', q_b, kc).astype(jnp.float32) * scale
        p = jax.nn.softmax(jnp.concatenate([s_loc, s_ctx], axis=-1), axis=-1).astype(v_b.dtype)
        return (jnp.einsum('bhnqk,bhnkd->bhnqd', p[..., :kloc], v_b)
                + jnp.einsum('bhnqk,bhkd->bhnqd', p[..., kloc:], vc))

    o = lax.map(row_block, (q_blk, jnp.asarray(r0), jnp.asarray(mask), jnp.asarray(dr), jnp.asarray(dc)))
    o = o.reshape(n_rb, bsz, NAT_HEADS, n_cb, qr, NAT_QC, NAT_DH).transpose(1, 0, 4, 3, 5, 2, 6)
    y_lat = o.reshape(bsz, n, d) @ w_out
    if not with_ctx_out:
        return y_lat, None
    s_c = jnp.einsum('bhqd,bhkd->bhqk', qc, kc).astype(jnp.float32) * scale
    o_c = jnp.einsum('bhqk,bhkd->bhqd', jax.nn.softmax(s_c, axis=-1).astype(vc.dtype), vc)
    y_ctx = o_c.transpose(0, 2, 1, 3).reshape(h_ctx.shape) @ w_out
    return y_lat, y_ctx


def _hier_moe(tok, w_group, b_group, w_expert, b_expert, w1, w3, w2):
    t_count, d = tok.shape
    g_logits = (tok @ w_group).astype(jnp.float32) + b_group
    g_p, g_idx = lax.top_k(jax.nn.softmax(g_logits, axis=-1), 1)
    e_logits = ((tok @ w_expert).astype(jnp.float32) + b_expert).reshape(t_count, N_GROUPS, EXPERTS_PER_GROUP)
    e_in = jnp.take_along_axis(e_logits, g_idx[:, :, None], axis=1)[:, 0]
    e_p, e_idx = lax.top_k(jax.nn.softmax(e_in, axis=-1), TOP_K_IN_GROUP)
    e_p = e_p / jnp.sum(e_p, axis=-1, keepdims=True)
    weight = (g_p * e_p).reshape(-1)
    expert = (g_idx * EXPERTS_PER_GROUP + e_idx).reshape(-1)
    token = jnp.repeat(jnp.arange(t_count, dtype=jnp.int32), TOP_K_IN_GROUP)
    n_assign = t_count * TOP_K_IN_GROUP
    order = jnp.argsort(expert)
    e_sorted = expert[order]
    counts = jnp.bincount(expert, length=N_EXPERTS)
    starts = jnp.cumsum(counts) - counts
    padded = (counts + MOE_BLOCK - 1) // MOE_BLOCK * MOE_BLOCK
    pad_end = jnp.cumsum(padded)
    pad_start = pad_end - padded
    dest = pad_start[e_sorted] + jnp.arange(n_assign) - starts[e_sorted]
    n_blocks = -(-n_assign // MOE_BLOCK) + N_EXPERTS
    cap = n_blocks * MOE_BLOCK
    slot_token = jnp.full((cap,), t_count, jnp.int32).at[dest].set(token[order])
    slot_weight = jnp.zeros((cap,), jnp.float32).at[dest].set(weight[order])
    block_expert = jnp.minimum(jnp.searchsorted(pad_end, jnp.arange(n_blocks) * MOE_BLOCK, side='right'),
                               N_EXPERTS - 1)
    tok_pad = jnp.concatenate([tok, jnp.zeros((1, d), tok.dtype)], axis=0)

    def run(xs):
        idx, e = xs
        xb = tok_pad[idx]
        return (jax.nn.silu(xb @ w1[e]) * (xb @ w3[e])) @ w2[e]

    y = lax.map(run, (slot_token.reshape(n_blocks, MOE_BLOCK), block_expert))
    y = y.reshape(cap, d).astype(jnp.float32) * slot_weight[:, None]
    out = jax.ops.segment_sum(y, slot_token, num_segments=t_count + 1)[:t_count]
    return out.astype(tok.dtype)


def setup_inputs(seed: int = 0) -> dict:
    key = jax.random.key(seed)
    ks = jax.random.split(key, 24)
    f32 = jnp.float32
    nrm = lambda k, shape, s: jax.random.normal(k, shape, f32) * s
    D = D_MODEL
    return {
        "x": nrm(ks[0], (BATCH, SEQ, D), 1.0),
        "c": nrm(ks[1], (BATCH, D), 1.0),
        "ctx": nrm(ks[2], (BATCH, CTX_LEN, D), 1.0),
        "c_ctx": nrm(ks[3], (D,), 1.0),
        "ada_w": nrm(ks[4], (DEPTH, D, 6 * D), 0.5 * D ** -0.5),
        "ada_b": nrm(ks[5], (DEPTH, 6 * D), 0.02),
        "ln_g": 1.0 + nrm(ks[6], (DEPTH, 2, D), 0.02),
        "ln_b": nrm(ks[7], (DEPTH, 2, D), 0.02),
        "gla_w_in": nrm(ks[8], (N_GLA_LAYERS, D, GLA_IN), D ** -0.5),
        "gla_w_gate": nrm(ks[9], (N_GLA_LAYERS, 2, GLA_GATE_RANK, GLA_QK), GLA_GATE_RANK ** -0.5),
        "gla_b_gate": nrm(ks[10], (N_GLA_LAYERS, 2, GLA_QK), 0.5),
        "gla_norm_g": 1.0 + nrm(ks[11], (N_GLA_LAYERS, GLA_DV), 0.02),
        "gla_w_out": nrm(ks[12], (N_GLA_LAYERS, GLA_VD, D), DEEPNORM_BETA * GLA_VD ** -0.5),
        "nat_w_in": nrm(ks[13], (N_NAT_LAYERS, D, 3 * D), D ** -0.5),
        "nat_rpb": nrm(ks[14], (N_NAT_LAYERS, NAT_HEADS, 2 * WIN_R - 1, 2 * WIN_C - 1), 0.1),
        "nat_w_out": nrm(ks[15], (N_NAT_LAYERS, D, D), DEEPNORM_BETA * D ** -0.5),
        "moe_w_group": nrm(ks[16], (DEPTH, D, N_GROUPS), D ** -0.5),
        "moe_b_group": nrm(ks[17], (DEPTH, N_GROUPS), 0.01),
        "moe_w_expert": nrm(ks[18], (DEPTH, D, N_EXPERTS), D ** -0.5),
        "moe_b_expert": nrm(ks[19], (DEPTH, N_EXPERTS), 0.01),
        "moe_w1": nrm(ks[20], (DEPTH, N_EXPERTS, D, D_EXPERT), D ** -0.5),
        "moe_w3": nrm(ks[21], (DEPTH, N_EXPERTS, D, D_EXPERT), D ** -0.5),
        "moe_w2": nrm(ks[22], (DEPTH, N_EXPERTS, D_EXPERT, D), DEEPNORM_BETA * D_EXPERT ** -0.5),
    }


def reference(x, c, ctx, c_ctx, ada_w, ada_b, ln_g, ln_b,
              gla_w_in, gla_w_gate, gla_b_gate, gla_norm_g, gla_w_out,
              nat_w_in, nat_rpb, nat_w_out,
              moe_w_group, moe_b_group, moe_w_expert, moe_b_expert, moe_w1, moe_w3, moe_w2):
    bsz, n, d = x.shape
    h_lat, h_ctx = x, ctx
    for i in range(DEPTH):
        last = i == DEPTH - 1
        j = i // N_MIXERS
        mod_l = (jax.nn.silu(c) @ ada_w[i] + ada_b[i])[:, None, :]
        mod_c = (jax.nn.silu(c_ctx) @ ada_w[i] + ada_b[i])[None, None, :]
        sh1_l, sc1_l, gt1_l, sh2_l, sc2_l, gt2_l = jnp.split(mod_l, 6, axis=-1)
        sh1_c, sc1_c, gt1_c, sh2_c, sc2_c, gt2_c = jnp.split(mod_c, 6, axis=-1)
        a_l = h_lat * (1.0 + sc1_l) + sh1_l
        a_c = h_ctx * (1.0 + sc1_c) + sh1_c
        if i % N_MIXERS == 0:
            y_l, y_c = _gla_mixer(a_l, a_c, gla_w_in[j], gla_w_gate[j], gla_b_gate[j], gla_norm_g[j], gla_w_out[j])
        else:
            y_l, y_c = _natten_mixer(a_l, a_c, nat_w_in[j], nat_rpb[j], nat_w_out[j], not last)
        h_lat = _layer_norm(DEEPNORM_ALPHA * h_lat + gt1_l * y_l, ln_g[i, 0], ln_b[i, 0])
        f_l = (h_lat * (1.0 + sc2_l) + sh2_l).reshape(-1, d)
        if last:
            y2_l = _hier_moe(f_l, moe_w_group[i], moe_b_group[i], moe_w_expert[i], moe_b_expert[i],
                             moe_w1[i], moe_w3[i], moe_w2[i]).reshape(bsz, n, d)
        else:
            h_ctx = _layer_norm(DEEPNORM_ALPHA * h_ctx + gt1_c * y_c, ln_g[i, 0], ln_b[i, 0])
            f_c = (h_ctx * (1.0 + sc2_c) + sh2_c).reshape(-1, d)
            y2 = _hier_moe(jnp.concatenate([f_l, f_c], axis=0), moe_w_group[i], moe_b_group[i],
                           moe_w_expert[i], moe_b_expert[i], moe_w1[i], moe_w3[i], moe_w2[i])
            y2_l = y2[:bsz * n].reshape(bsz, n, d)
            h_ctx = _layer_norm(DEEPNORM_ALPHA * h_ctx + gt2_c * y2[bsz * n:].reshape(h_ctx.shape),
                                ln_g[i, 1], ln_b[i, 1])
        h_lat = _layer_norm(DEEPNORM_ALPHA * h_lat + gt2_l * y2_l, ln_g[i, 1], ln_b[i, 1])
    return h_lat
```

```cpp
#include <hip/hip_runtime.h>
#include <cstdio>
#include <cstdint>

#ifndef MK_MULTI
#define MK_MULTI 0
#endif

#define GAS __attribute__((address_space(1)))
#define LAS __attribute__((address_space(3)))
typedef unsigned short bf16;
typedef float f32x4 __attribute__((ext_vector_type(4)));
typedef float f32x2 __attribute__((ext_vector_type(2)));
typedef short bf16x8 __attribute__((ext_vector_type(8)));
typedef unsigned v4u __attribute__((ext_vector_type(4)));
typedef unsigned v2u __attribute__((ext_vector_type(2)));

constexpr int D = 2048, NB = 4, SEQ = 4096, CTXL = 256, GW = 64;
constexpr int NLAT = NB * SEQ;
constexpr int NCTX = NB * CTXL;
constexpr int T = NLAT + NCTX;
constexpr int GLA_H = 4, GLA_DK = 256, GLA_DV = 512, GLA_QK = 1024, GLA_VD = 2048, GLA_IN = 6176, GLA_INP = 6400;
constexpr int NAT_H = 16, NAT_DH = 128, NAT_IN = 6144;
constexpr int NEXP = 16, DE = 1024;
constexpr int MODW = 6 * D;
constexpr float LN_EPS = 1e-5f;
constexpr float ALPHA = 1.41421356237f;
constexpr int NWAVES = 8, NTHR = 512;

constexpr size_t MiB = 1u << 20;
constexpr size_t WS_CTL = 0, CTL_ZERO_BYTES = 1 * MiB;
constexpr size_t WS_MOD = 1 * MiB;
constexpr size_t WS_LIST = 2 * MiB;
constexpr size_t WS_LW = 4 * MiB;
constexpr size_t WS_GLR = 6 * MiB;
constexpr size_t WS_WT_GLA_IN = 10 * MiB;
constexpr size_t WS_WT_GLA_OUT = 35 * MiB;
constexpr size_t WS_WT_NAT_IN = 43 * MiB;
constexpr size_t WS_WT_NAT_OUT = 67 * MiB;
constexpr size_t WS_WT_MOE13 = 75 * MiB;
constexpr size_t WS_WT_MOE2 = 331 * MiB;
constexpr size_t WS_H = 459 * MiB;
constexpr size_t WS_AF = 595 * MiB;
constexpr size_t WS_P = 663 * MiB;
constexpr size_t WS_HMID = WS_P;
constexpr size_t WS_Y2 = WS_P + 76 * MiB;
constexpr size_t WS_G = 876 * MiB;
constexpr size_t WS_Y = 1012 * MiB;
constexpr size_t WS_END = 1148 * MiB;
constexpr int CW_BAR = 4096;
constexpr int CW_CNT = 16384;

constexpr int LDS_BYTES = 147456;
constexpr int MISC_OFF = LDS_BYTES - 256;

__device__ __forceinline__ unsigned f2bf(float f) { unsigned u = __builtin_bit_cast(unsigned, f); return (u + 0x7fffu + ((u >> 16) & 1u)) >> 16; }
__device__ __forceinline__ unsigned pk2(float lo, float hi) { return f2bf(lo) | (f2bf(hi) << 16); }
__device__ __forceinline__ float bf2f(unsigned short b) { return __builtin_bit_cast(float, ((unsigned)b) << 16); }
__device__ __forceinline__ float bflo(unsigned w) { return __builtin_bit_cast(float, w << 16); }
__device__ __forceinline__ float bfhi(unsigned w) { return __builtin_bit_cast(float, w & 0xffff0000u); }
__device__ __forceinline__ float silu_f(float x) { return x / (1.f + __expf(-x)); }
__device__ __forceinline__ float wave_sum(float v) {
#pragma unroll
    for (int o = 1; o < 64; o <<= 1) v += __shfl_xor(v, o);
    return v;
}
__device__ __forceinline__ float wave_max(float v) {
#pragma unroll
    for (int o = 1; o < 64; o <<= 1) v = fmaxf(v, __shfl_xor(v, o));
    return v;
}

#define XB_TMO      128
#define XB_XCNT(j)  (256  + 64 * (j))
#define XB_XSUB(j)  (1280 + 64 * (j))
#define XB_XGEN(j)  (2304 + 64 * (j))
#define XB_TOP      3328
#define XB_TOPGEN   3392
#define XCD_BAR_WORDS 3456
#define XB_SPIN_CAP (1u << 18)

__device__ __forceinline__ unsigned xb_ld(unsigned* p)              { return __hip_atomic_load(p, __ATOMIC_RELAXED, __HIP_MEMORY_SCOPE_AGENT); }
__device__ __forceinline__ unsigned xb_add(unsigned* p, unsigned v) { return __hip_atomic_fetch_add(p, v, __ATOMIC_RELAXED, __HIP_MEMORY_SCOPE_AGENT); }
__device__ __forceinline__ unsigned xb_xcc_id() { return (unsigned)__builtin_amdgcn_s_getreg((3 << 11) | 20) & 0xFu; }
#define XB_SPIN(cond, bar) do { unsigned _sp = 0; while (cond) { __builtin_amdgcn_s_sleep(1); \
    if ((++_sp & 255u) == 0u) { if (xb_ld(&(bar)[XB_TMO])) break; if (_sp > XB_SPIN_CAP) { atomicAdd(&(bar)[XB_TMO], 1u); break; } } } } while (0)

struct XcdBarrier { unsigned* bar; unsigned x; volatile LAS unsigned* st; };

__device__ __forceinline__ XcdBarrier xcd_barrier_post(unsigned* bar, volatile LAS unsigned* st) {
    XcdBarrier b; b.bar = bar; b.x = xb_xcc_id(); b.st = st;
    if (threadIdx.x == 0) (void)xb_add(&bar[XB_XCNT(b.x)], 1u);
    return b;
}
__device__ __forceinline__ void xcd_barrier_complete(unsigned* bar, unsigned x, unsigned& nloc, unsigned& nx) {
    const unsigned G = gridDim.x * gridDim.y * gridDim.z;
    unsigned sum, cnt, mine, sp = 0u;
    for (;;) {
        sum = 0u; cnt = 0u; mine = 0u;
#pragma unroll
        for (unsigned j = 0; j < 16; ++j) { const unsigned c = xb_ld(&bar[XB_XCNT(j)]); sum += c; cnt += (c > 0u) ? 1u : 0u; mine = (j == x) ? c : mine; }
        if (sum == G) break;
        __builtin_amdgcn_s_sleep(1);
        if ((++sp & 255u) == 0u) { if (xb_ld(&bar[XB_TMO])) break; if (sp > XB_SPIN_CAP) { atomicAdd(&bar[XB_TMO], 1u); break; } }
    }
    nloc = mine > 0u ? mine : 1u; nx = cnt > 0u ? cnt : 1u;
}
__device__ __forceinline__ void xcd_barrier(const XcdBarrier& b) {
    asm volatile("s_waitcnt vmcnt(0)" ::: "memory");
    __syncthreads();
    if (threadIdx.x == 0) {
        unsigned* bar = b.bar;
        __builtin_amdgcn_s_waitcnt(0);
        unsigned nloc = b.st[0], nx = b.st[1];
        if (nloc == 0u) { xcd_barrier_complete(bar, b.x, nloc, nx); b.st[0] = nloc; b.st[1] = nx; }
        const unsigned old = xb_add(&bar[XB_XSUB(b.x)], 1u);
        const unsigned gen = old / nloc;
        if (old + 1u == (gen + 1u) * nloc) {
            __builtin_amdgcn_fence(__ATOMIC_RELEASE, "agent");
            asm volatile("s_waitcnt vmcnt(0)" ::: "memory");
            const unsigned og = xb_add(&bar[XB_TOP], 1u);
            const unsigned tg = og / nx;
            if (og + 1u == (tg + 1u) * nx) xb_add(&bar[XB_TOPGEN], 1u);
            else XB_SPIN(xb_ld(&bar[XB_TOPGEN]) == tg, bar);
            __builtin_amdgcn_fence(__ATOMIC_ACQUIRE, "agent");
            xb_add(&bar[XB_XGEN(b.x)], 1u);
            asm volatile("s_waitcnt vmcnt(0)" ::: "memory");
        } else {
            XB_SPIN(xb_ld(&bar[XB_XGEN(b.x)]) == gen, bar);
            __builtin_amdgcn_fence(__ATOMIC_ACQUIRE, "agent");
            asm volatile("s_waitcnt vmcnt(0)" ::: "memory");
        }
    }
    __syncthreads();
}

struct Frame {
    LAS unsigned char* lds;
    volatile LAS unsigned* MISC;
    int tid, lane, wave, G, gw, NGW;
};
struct Args { const float* in[23]; float* out; unsigned char* ws; int ph_lo, ph_hi; };


__device__ __forceinline__ void p_ada(Frame& F, const Args& A) {
    LAS float* sS = (LAS float*)(F.lds);
    LAS float* red = sS + 5 * 2048;
    for (int i = F.tid; i < 5 * 2048; i += NTHR) { const int r = i >> 11, k = i & 2047; const float cv = r < 4 ? (A.in[1])[r * 2048 + k] : (A.in[3])[k]; sS[i] = silu_f(cv); }
    __syncthreads();
    for (int item = blockIdx.x; item < 192; item += F.G) {
        const int l = item / 96, cg = item % 96;
        const float* W = (A.in[4]) + (size_t)l * D * MODW + cg * 128;
        const int half = F.lane >> 5, cl = F.lane & 31, kbase = F.wave * 256;
        f32x4 acc[5];
#pragma unroll
        for (int r = 0; r < 5; ++r) acc[r] = (f32x4){0.f, 0.f, 0.f, 0.f};
#pragma unroll 4
        for (int i = 0; i < 128; ++i) {
            const int k = kbase + 2 * i + half;
            const f32x4 w = *(const f32x4*)(W + (size_t)k * MODW + 4 * cl);
#pragma unroll
            for (int r = 0; r < 5; ++r) acc[r] += sS[r * 2048 + k] * w;
        }
        const int slot = F.wave * 2 + half;
#pragma unroll
        for (int r = 0; r < 5; ++r) *(LAS f32x4*)(red + (slot * 5 + r) * 128 + 4 * cl) = acc[r];
        __syncthreads();
        for (int o = F.tid; o < 640; o += NTHR) {
            const int r = o >> 7, cc = o & 127; float s = 0.f;
#pragma unroll
            for (int sl = 0; sl < 16; ++sl) s += red[(sl * 5 + r) * 128 + cc];
            const int col = cg * 128 + cc;
            ((float*)(A.ws + WS_MOD))[(size_t)(l * 5 + r) * MODW + col] = s + (A.in[5])[l * MODW + col];
        }
        __syncthreads();
    }
}
__device__ __forceinline__ void tr_item(const float* src, int K, int N, bf16* dst, int item, int lane, int mode) {
    const int nblk = (N + 63) >> 6, kb = item / nblk, nb = item - kb * nblk, k0 = kb * 64, n = nb * 64 + lane;
    const bool ok = n < N;
    const float* sp = src + (size_t)k0 * N + (ok ? n : 0);
    float v[64];
#pragma unroll
    for (int kk = 0; kk < 64; ++kk) v[kk] = sp[(size_t)kk * N];
    const int drow = mode == 0 ? n : ((n >> 7) * 256 + (mode - 1) * 128 + (n & 127));
    if (ok) {
        bf16* dp = dst + (size_t)drow * K + k0;
#pragma unroll
        for (int cc = 0; cc < 8; ++cc) { v4u o; o.x = pk2(v[8 * cc], v[8 * cc + 1]); o.y = pk2(v[8 * cc + 2], v[8 * cc + 3]); o.z = pk2(v[8 * cc + 4], v[8 * cc + 5]); o.w = pk2(v[8 * cc + 6], v[8 * cc + 7]);
            *(v4u*)(dp + 8 * cc) = o; }
    }
}
__device__ __forceinline__ void p_transposes(Frame& F, const Args& A) {
    constexpr int I0 = 32 * 97, I1 = 32 * 32, I2 = 32 * 96, I3 = 32 * 32, IM = 512;
    constexpr int NIT = I0 + I1 + I2 + I3 + 3 * 32 * IM;
    for (int it = F.gw; it < NIT; it += F.NGW) {
        int r = it;
        if (r < I0) { tr_item((A.in[8]), D, GLA_IN, ((bf16*)(A.ws + WS_WT_GLA_IN)), r, F.lane, 0); continue; } r -= I0;
        if (r < I1) { tr_item((A.in[12]), D, D, ((bf16*)(A.ws + WS_WT_GLA_OUT)), r, F.lane, 0); continue; } r -= I1;
        if (r < I2) { tr_item((A.in[13]), D, NAT_IN, ((bf16*)(A.ws + WS_WT_NAT_IN)), r, F.lane, 0); continue; } r -= I2;
        if (r < I3) { tr_item((A.in[15]), D, D, ((bf16*)(A.ws + WS_WT_NAT_OUT)), r, F.lane, 0); continue; } r -= I3;
        const int which = r / (32 * IM), rr = r - which * (32 * IM), le = rr / IM, ii = rr - le * IM;
        if (which == 0) tr_item((A.in[20]) + (size_t)le * D * DE, D, DE, ((bf16*)(A.ws + WS_WT_MOE13)) + (size_t)le * 2048 * 2048, ii, F.lane, 1);
        else if (which == 1) tr_item((A.in[21]) + (size_t)le * D * DE, D, DE, ((bf16*)(A.ws + WS_WT_MOE13)) + (size_t)le * 2048 * 2048, ii, F.lane, 2);
        else tr_item((A.in[22]) + (size_t)le * DE * D, DE, D, ((bf16*)(A.ws + WS_WT_MOE2)) + (size_t)le * 2048 * 1024, ii, F.lane, 0);
    }
    { v4u* z = (v4u*)(((bf16*)(A.ws + WS_WT_GLA_IN)) + (size_t)GLA_IN * D); const int n16 = (GLA_INP - GLA_IN) * D * 2 / 16;
      for (int i = F.gw * 64 + F.lane; i < n16; i += F.NGW * 64) z[i] = (v4u){0u, 0u, 0u, 0u}; }
}

__device__ __forceinline__ void p_modulate0(Frame& F, const Args& A) {
    for (int row = F.gw; row < T; row += F.NGW) {
        const int r = row < NLAT ? (row >> 12) : 4;
        const float* src = row < NLAT ? (A.in[0]) + (size_t)row * D : (A.in[2]) + (size_t)(row - NLAT) * D;
        const float* mp = ((float*)(A.ws + WS_MOD)) + (size_t)(0 * 5 + r) * MODW;
        bf16* dst = ((bf16*)(A.ws + WS_AF)) + (size_t)row * D;
#pragma unroll
        for (int j = 0; j < 8; ++j) {
            const int col = j * 256 + F.lane * 4;
            const f32x4 xv = *(const f32x4*)(src + col), sh = *(const f32x4*)(mp + col), sc = *(const f32x4*)(mp + D + col);
            const f32x4 v = xv * (1.f + sc) + sh;
            v2u o; o.x = pk2(v.x, v.y); o.y = pk2(v.z, v.w);
            *(v2u*)(dst + col) = o;
        }
    }
}

__device__ __forceinline__ void wave_gemm64(const bf16* const (&pa)[4], const bf16* const (&pb)[4], int K, f32x4 (&acc)[4][4]) {
#pragma unroll
    for (int i = 0; i < 4; ++i)
#pragma unroll
        for (int j = 0; j < 4; ++j) acc[i][j] = (f32x4){0.f, 0.f, 0.f, 0.f};
#pragma unroll 2
    for (int k0 = 0; k0 < K; k0 += 32) {
        bf16x8 a[4], b[4];
#pragma unroll
        for (int i = 0; i < 4; ++i) { a[i] = *(const bf16x8*)(pa[i] + k0); b[i] = *(const bf16x8*)(pb[i] + k0); }
#pragma unroll
        for (int i = 0; i < 4; ++i)
#pragma unroll
            for (int j = 0; j < 4; ++j) acc[i][j] = __builtin_amdgcn_mfma_f32_16x16x32_bf16(b[j], a[i], acc[i][j], 0, 0, 0);
    }
}

__device__ __forceinline__ void p_gemm_gla_in(Frame& F, const Args& A) {
    const int fr = F.lane & 15, fq = F.lane >> 4;
    constexpr int NT = GLA_INP / 64, MT = T / 64;
    for (int it = F.gw; it < MT * NT; it += F.NGW) {
        const int mt = it / NT, nt = it - mt * NT, m0 = mt * 64, n0 = nt * 64;
        const bf16* pa[4]; const bf16* pb[4];
#pragma unroll
        for (int i = 0; i < 4; ++i) { pa[i] = ((bf16*)(A.ws + WS_AF)) + (size_t)(m0 + 16 * i + fr) * D + 8 * fq; pb[i] = ((bf16*)(A.ws + WS_WT_GLA_IN)) + (size_t)(n0 + 16 * i + fr) * D + 8 * fq; }
        f32x4 acc[4][4];
        wave_gemm64(pa, pb, D, acc);
#pragma unroll
        for (int i = 0; i < 4; ++i)
#pragma unroll
            for (int j = 0; j < 4; ++j) {
                const int row = m0 + 16 * i + fr, col = n0 + 16 * j + 4 * fq; const f32x4 v = acc[i][j];
                if (col < 6144) { v2u o; o.x = pk2(v.x, v.y); o.y = pk2(v.z, v.w); *(v2u*)(((bf16*)(A.ws + WS_P)) + (size_t)row * GLA_INP + col) = o; }
                else if (col < GLA_IN) *(f32x4*)(((float*)(A.ws + WS_GLR)) + (size_t)row * 32 + (col - 6144)) = v;
            }
    }
}
template <bool OUT_BF16>
__device__ __forceinline__ void p_gemm_plain(Frame& F, const Args&, const bf16* Am, const bf16* Bt, int M, int N, int K, void* Cout, int ldc) {
    const int fr = F.lane & 15, fq = F.lane >> 4;
    const int NT = N / 64, MT = M / 64;
    for (int it = F.gw; it < MT * NT; it += F.NGW) {
        const int mt = it / NT, nt = it - mt * NT, m0 = mt * 64, n0 = nt * 64;
        const bf16* pa[4]; const bf16* pb[4];
#pragma unroll
        for (int i = 0; i < 4; ++i) { pa[i] = Am + (size_t)(m0 + 16 * i + fr) * K + 8 * fq; pb[i] = Bt + (size_t)(n0 + 16 * i + fr) * K + 8 * fq; }
        f32x4 acc[4][4];
        wave_gemm64(pa, pb, K, acc);
#pragma unroll
        for (int i = 0; i < 4; ++i)
#pragma unroll
            for (int j = 0; j < 4; ++j) {
                const int row = m0 + 16 * i + fr, col = n0 + 16 * j + 4 * fq; const f32x4 v = acc[i][j];
                if (OUT_BF16) { v2u o; o.x = pk2(v.x, v.y); o.y = pk2(v.z, v.w); *(v2u*)((bf16*)Cout + (size_t)row * ldc + col) = o; }
                else *(f32x4*)((float*)Cout + (size_t)row * ldc + col) = v;
            }
    }
}

__device__ __forceinline__ void p_gla_prep(Frame& F, const Args& A) {
    const float freq = exp2f(-(float)F.lane * (13.287712379549449f / 64.f));
    for (int row = F.gw; row < T; row += F.NGW) {
        bf16* pr = ((bf16*)(A.ws + WS_P)) + (size_t)row * GLA_INP;
        if (row < NLAT) {
            const int n = row & 4095;
            float c0, s0, c1, s1;
            { const float a0 = (float)(n >> 6) * freq, a1 = (float)(n & 63) * freq; c0 = __cosf(a0); s0 = __sinf(a0); c1 = __cosf(a1); s1 = __sinf(a1); }
#pragma unroll
            for (int u = 0; u < 16; ++u) {
                const int p = F.lane + 64 * u, which = p >> 9, hp = p & 511, h = hp >> 7, ax = (hp >> 6) & 1;
                const int col1 = which * 1024 + h * 256 + ax * 128 + F.lane, col2 = col1 + 64;
                const float x1 = bf2f(pr[col1]), x2 = bf2f(pr[col2]);
                const float cs = ax ? c1 : c0, sn = ax ? s1 : s0, sc = which == 0 ? 0.0625f : 1.f;
                pr[col1] = (bf16)f2bf((x1 * cs - x2 * sn) * sc);
                pr[col2] = (bf16)f2bf((x1 * sn + x2 * cs) * sc);
            }
        } else {
#pragma unroll
            for (int u = 0; u < 16; ++u) { const int col = F.lane + 64 * u; pr[col] = (bf16)f2bf(bf2f(pr[col]) * 0.0625f); }
        }
        float gl[32];
        { const f32x4* gp = (const f32x4*)(((float*)(A.ws + WS_GLR)) + (size_t)row * 32);
#pragma unroll
          for (int q = 0; q < 8; ++q) { const f32x4 t = gp[q]; gl[4 * q] = t.x; gl[4 * q + 1] = t.y; gl[4 * q + 2] = t.z; gl[4 * q + 3] = t.w; } }
        float* go = ((float*)(A.ws + WS_G)) + (size_t)row * 2048;
#pragma unroll
        for (int dir = 0; dir < 2; ++dir) {
#pragma unroll 1
            for (int u = 0; u < 16; ++u) {
                const int j = F.lane + 64 * u;
                const float* wg = (A.in[9]) + (size_t)dir * 16 * 1024 + j;
                float z = (A.in[10])[dir * 1024 + j];
#pragma unroll
                for (int r = 0; r < 16; ++r) z += gl[dir * 16 + r] * wg[r * 1024];
                const float ls = fminf(z, 0.f) - log1pf(__expf(-fabsf(z)));
                go[dir * 1024 + j] = ls * 0.0625f;
            }
        }
    }
}

__device__ __forceinline__ int scan_row(int b, int dir, int st) {
    if (dir == 0) return st < CTXL ? NLAT + b * CTXL + st : b * SEQ + (st - CTXL);
    return st < CTXL ? NLAT + b * CTXL + (CTXL - 1 - st) : b * SEQ + (SEQ - 1 - (st - CTXL));
}
__device__ __forceinline__ void p_gla_scan(Frame& F, const Args& A) {
    constexpr int TB = 16, RS = 288;
    LAS float* qs = (LAS float*)F.lds; LAS float* ks = qs + TB * RS; LAS float* es = ks + TB * RS; LAS float* vs = es + TB * RS; LAS float* os = vs + TB * 64;
    for (int item = blockIdx.x; item < 256; item += F.G) {
        const int chain = item >> 3, dvg = item & 7, b = chain >> 3, h = (chain >> 1) & 3, dir = chain & 1;
        float* Ob = dir == 0 ? ((float*)(A.ws + WS_H)) : ((float*)(A.ws + WS_Y));
        const int s = F.lane & 7, dvl = F.wave * 8 + (F.lane >> 3);
        float S[32];
#pragma unroll
        for (int i = 0; i < 32; ++i) S[i] = 0.f;
        for (int st0 = 0; st0 < CTXL + SEQ; st0 += TB) {
            { const int stp = F.tid >> 5, dsub = F.tid & 31, row = scan_row(b, dir, st0 + stp), d0 = dsub * 8;
              const bf16* pr = ((bf16*)(A.ws + WS_P)) + (size_t)row * GLA_INP + h * 256 + d0;
              const v4u qv = *(const v4u*)pr, kv = *(const v4u*)(pr + 1024);
              const f32x4* gp = (const f32x4*)(((float*)(A.ws + WS_G)) + (size_t)row * 2048 + dir * 1024 + h * 256 + d0);
              const f32x4 g0 = gp[0], g1 = gp[1];
              const int lo = stp * RS + (dsub >> 2) * 36 + (dsub & 3) * 8;
              *(LAS f32x4*)(qs + lo) = (f32x4){bflo(qv.x), bfhi(qv.x), bflo(qv.y), bfhi(qv.y)}; *(LAS f32x4*)(qs + lo + 4) = (f32x4){bflo(qv.z), bfhi(qv.z), bflo(qv.w), bfhi(qv.w)};
              *(LAS f32x4*)(ks + lo) = (f32x4){bflo(kv.x), bfhi(kv.x), bflo(kv.y), bfhi(kv.y)}; *(LAS f32x4*)(ks + lo + 4) = (f32x4){bflo(kv.z), bfhi(kv.z), bflo(kv.w), bfhi(kv.w)};
              *(LAS f32x4*)(es + lo) = (f32x4){__expf(g0.x), __expf(g0.y), __expf(g0.z), __expf(g0.w)}; *(LAS f32x4*)(es + lo + 4) = (f32x4){__expf(g1.x), __expf(g1.y), __expf(g1.z), __expf(g1.w)};
              if (F.tid < 128) { const int st2 = F.tid >> 3, c8 = (F.tid & 7) * 8, row2 = scan_row(b, dir, st0 + st2);
                  const v4u vv = *(const v4u*)(((bf16*)(A.ws + WS_P)) + (size_t)row2 * GLA_INP + 2048 + h * 512 + dvg * 64 + c8);
                  *(LAS f32x4*)(vs + st2 * 64 + c8) = (f32x4){bflo(vv.x), bfhi(vv.x), bflo(vv.y), bfhi(vv.y)}; *(LAS f32x4*)(vs + st2 * 64 + c8 + 4) = (f32x4){bflo(vv.z), bfhi(vv.z), bflo(vv.w), bfhi(vv.w)}; } }
            __syncthreads();
#pragma unroll 2
            for (int tt = 0; tt < TB; ++tt) {
                const LAS float* qp = qs + tt * RS + s * 36; const LAS float* kp = ks + tt * RS + s * 36; const LAS float* ep = es + tt * RS + s * 36;
                const float v = vs[tt * 64 + dvl];
                float part = 0.f;
#pragma unroll
                for (int i4 = 0; i4 < 8; ++i4) {
                    const f32x4 e = *(const LAS f32x4*)(ep + 4 * i4), k4 = *(const LAS f32x4*)(kp + 4 * i4), q4 = *(const LAS f32x4*)(qp + 4 * i4);
                    S[4 * i4 + 0] = S[4 * i4 + 0] * e.x + k4.x * v; part += q4.x * S[4 * i4 + 0];
                    S[4 * i4 + 1] = S[4 * i4 + 1] * e.y + k4.y * v; part += q4.y * S[4 * i4 + 1];
                    S[4 * i4 + 2] = S[4 * i4 + 2] * e.z + k4.z * v; part += q4.z * S[4 * i4 + 2];
                    S[4 * i4 + 3] = S[4 * i4 + 3] * e.w + k4.w * v; part += q4.w * S[4 * i4 + 3];
                }
                part += __shfl_xor(part, 1); part += __shfl_xor(part, 2); part += __shfl_xor(part, 4);
                if (s == 0) os[tt * 64 + dvl] = part;
            }
            __syncthreads();
            { const int stp = F.tid >> 5, c2 = (F.tid & 31) * 2, row = scan_row(b, dir, st0 + stp);
              *(f32x2*)(Ob + (size_t)row * D + h * 512 + dvg * 64 + c2) = *(const LAS f32x2*)(os + stp * 64 + c2); }
        }
        __syncthreads();
    }
}

__device__ __forceinline__ void p_gla_finish(Frame& F, const Args& A) {
    for (int it = F.gw; it < T * 4; it += F.NGW) {
        const int row = it >> 2, h = it & 3; const size_t off = (size_t)row * D + h * 512 + F.lane * 8;
        const f32x4 a0 = *(const f32x4*)(((float*)(A.ws + WS_H)) + off), a1 = *(const f32x4*)(((float*)(A.ws + WS_H)) + off + 4), b0 = *(const f32x4*)(((float*)(A.ws + WS_Y)) + off), b1 = *(const f32x4*)(((float*)(A.ws + WS_Y)) + off + 4);
        const f32x4 o0 = a0 + b0, o1 = a1 + b1;
        float ss = (o0.x * o0.x + o0.y * o0.y) + (o0.z * o0.z + o0.w * o0.w) + (o1.x * o1.x + o1.y * o1.y) + (o1.z * o1.z + o1.w * o1.w);
        ss = wave_sum(ss);
        const float rs = 1.f / sqrtf(ss * (1.f / 512.f) + LN_EPS);
        const f32x4 g0 = *(const f32x4*)((A.in[11]) + F.lane * 8), g1 = *(const f32x4*)((A.in[11]) + F.lane * 8 + 4);
        const v4u rv = *(const v4u*)(((bf16*)(A.ws + WS_P)) + (size_t)row * GLA_INP + 4096 + h * 512 + F.lane * 8);
        const float r0 = bflo(rv.x), r1 = bfhi(rv.x), r2 = bflo(rv.y), r3 = bfhi(rv.y), r4 = bflo(rv.z), r5 = bfhi(rv.z), r6 = bflo(rv.w), r7 = bfhi(rv.w);
        v4u o;
        o.x = pk2(o0.x * rs * g0.x * silu_f(r0), o0.y * rs * g0.y * silu_f(r1));
        o.y = pk2(o0.z * rs * g0.z * silu_f(r2), o0.w * rs * g0.w * silu_f(r3));
        o.z = pk2(o1.x * rs * g1.x * silu_f(r4), o1.y * rs * g1.y * silu_f(r5));
        o.w = pk2(o1.z * rs * g1.z * silu_f(r6), o1.w * rs * g1.w * silu_f(r7));
        *(v4u*)(((bf16*)(A.ws + WS_AF)) + off) = o;
    }
}

template <int L>
__device__ __forceinline__ void p_ln1(Frame& F, const Args& A) {
    constexpr int NR = L == 0 ? T : NLAT;
    const float* lg = (A.in[6]) + (size_t)(L * 2 + 0) * D; const float* lb = (A.in[7]) + (size_t)(L * 2 + 0) * D;
    const float* wgp = (A.in[16]) + (size_t)L * D * 4; const float* wep = (A.in[18]) + (size_t)L * D * 16;
    for (int row = F.gw; row < NR; row += F.NGW) {
        int l4 = F.lane * 4; asm volatile("" : "+v"(l4));
        const int r = row < NLAT ? (row >> 12) : 4;
        const float* hin = L == 0 ? (row < NLAT ? (A.in[0]) + (size_t)row * D : (A.in[2]) + (size_t)(row - NLAT) * D) : ((float*)(A.ws + WS_H)) + (size_t)row * D;
        const float* mp = ((float*)(A.ws + WS_MOD)) + (size_t)(L * 5 + r) * MODW;
        const float* yr = ((float*)(A.ws + WS_Y)) + (size_t)row * D;
        f32x4 v[8]; float sm = 0.f;
#pragma unroll
        for (int j = 0; j < 8; ++j) { const int col = j * 256 + l4;
            v[j] = ALPHA * *(const f32x4*)(hin + col) + *(const f32x4*)(mp + 2 * D + col) * *(const f32x4*)(yr + col);
            sm += (v[j].x + v[j].y) + (v[j].z + v[j].w); }
        const float mean = wave_sum(sm) * (1.f / D); float sq = 0.f;
#pragma unroll
        for (int j = 0; j < 8; ++j) { v[j] = v[j] - mean; sq += (v[j].x * v[j].x + v[j].y * v[j].y) + (v[j].z * v[j].z + v[j].w * v[j].w); }
        const float rstd = 1.f / sqrtf(wave_sum(sq) * (1.f / D) + LN_EPS);
        float lg20[20];
#pragma unroll
        for (int q = 0; q < 20; ++q) lg20[q] = 0.f;
#pragma unroll
        for (int j = 0; j < 8; ++j) { const int col = j * 256 + l4;
            const f32x4 hn = v[j] * rstd * *(const f32x4*)(lg + col) + *(const f32x4*)(lb + col);
            *(f32x4*)(((float*)(A.ws + WS_H)) + (size_t)row * D + col) = hn;
            const f32x4 f = hn * (1.f + *(const f32x4*)(mp + 4 * D + col)) + *(const f32x4*)(mp + 3 * D + col);
            v2u o; o.x = pk2(f.x, f.y); o.y = pk2(f.z, f.w); *(v2u*)(((bf16*)(A.ws + WS_AF)) + (size_t)row * D + col) = o;
            v[j] = f;
        }
        asm volatile("" ::: "memory");
#pragma unroll
        for (int j = 0; j < 8; ++j) {
            const float* wgb = wgp + (size_t)(j * 256 + l4) * 4; const float* web = wep + (size_t)(j * 256 + l4) * 16;
#pragma unroll
            for (int e = 0; e < 4; ++e) { const float fe = v[j][e];
                const f32x4 wg = *(const f32x4*)(wgb + e * 4);
                lg20[0] += fe * wg.x; lg20[1] += fe * wg.y; lg20[2] += fe * wg.z; lg20[3] += fe * wg.w;
#pragma unroll
                for (int q = 0; q < 4; ++q) { const f32x4 we = *(const f32x4*)(web + e * 16 + 4 * q);
                    lg20[4 + 4 * q] += fe * we.x; lg20[5 + 4 * q] += fe * we.y; lg20[6 + 4 * q] += fe * we.z; lg20[7 + 4 * q] += fe * we.w; }
                asm volatile("" ::: "memory"); }
        }
#pragma unroll
        for (int q = 0; q < 20; ++q) lg20[q] = wave_sum(lg20[q]);
        float gl[4];
#pragma unroll
        for (int q = 0; q < 4; ++q) gl[q] = lg20[q] + (A.in[17])[L * 4 + q];
        int gi = 0; float gm = gl[0];
#pragma unroll
        for (int q = 1; q < 4; ++q) if (gl[q] > gm) { gm = gl[q]; gi = q; }
        float gs = 0.f;
#pragma unroll
        for (int q = 0; q < 4; ++q) gs += __expf(gl[q] - gm);
        const float gp = 1.f / gs;
        float el[4];
#pragma unroll
        for (int i = 0; i < 4; ++i) { float t = lg20[4 + i];
#pragma unroll
            for (int gg = 1; gg < 4; ++gg) t = (gi == gg) ? lg20[4 + 4 * gg + i] : t;
            el[i] = t + (A.in[19])[L * 16 + gi * 4 + i]; }
        int i0 = 0; float m0 = el[0];
#pragma unroll
        for (int i = 1; i < 4; ++i) if (el[i] > m0) { m0 = el[i]; i0 = i; }
        int i1 = -1; float m1 = -3.0e38f;
#pragma unroll
        for (int i = 0; i < 4; ++i) if (i != i0 && el[i] > m1) { m1 = el[i]; i1 = i; }
        const float p0 = 1.f / (1.f + __expf(m1 - m0)), p1 = 1.f - p0;
        if (F.lane < 2) {
            const int e = gi * 4 + (F.lane == 0 ? i0 : i1); const float w = gp * (F.lane == 0 ? p0 : p1);
            const unsigned pos = atomicAdd(((unsigned*)(A.ws + WS_CTL)) + CW_CNT + L * 2048 + e * 64, 1u);
            ((int*)(A.ws + WS_LIST))[(size_t)e * T + pos] = row * 2 + F.lane; ((float*)(A.ws + WS_LW))[(size_t)e * T + pos] = w;
        }
    }
}

__device__ __forceinline__ void moe_table(Frame& F, const Args& A, int L, LAS int* tab) {
    __syncthreads();
    if (F.tid == 0) { int acc = 0;
        for (int e = 0; e < 16; ++e) { const int c = (int)__hip_atomic_load(((unsigned*)(A.ws + WS_CTL)) + CW_CNT + L * 2048 + e * 64, __ATOMIC_RELAXED, __HIP_MEMORY_SCOPE_AGENT); tab[e] = acc; tab[32 + e] = c; acc += (c + 255) >> 8; }
        tab[16] = acc; }
    __syncthreads();
}
template <int L>
__device__ __forceinline__ void p_moe1(Frame& F, const Args& A) {
    LAS int* tab = (LAS int*)F.lds; moe_table(F, A, L, tab);
    const int fr = F.lane & 15, fq = F.lane >> 4, nsub = tab[16] * 4;
    for (int it = F.gw; it < nsub * 32; it += F.NGW) {
        const int sub = it >> 5, g = it & 31, tile = sub >> 2;
        int e = 0;
#pragma unroll
        for (int q = 1; q < 16; ++q) e = (tile >= tab[q]) ? q : e;
        const int cn = tab[32 + e], slot0 = (tile - tab[e]) * 256 + (sub & 3) * 64, j0 = 32 * g;
        const bf16* Bt = ((bf16*)(A.ws + WS_WT_MOE13)) + (size_t)(L * 16 + e) * 2048 * 2048;
        const bf16* pa[4]; const bf16* pb[4];
#pragma unroll
        for (int i = 0; i < 4; ++i) { const int slot = slot0 + 16 * i + fr; const int tok = slot < cn ? (((int*)(A.ws + WS_LIST))[(size_t)e * T + slot] >> 1) : 0;
            pa[i] = ((bf16*)(A.ws + WS_AF)) + (size_t)tok * D + 8 * fq;
            const int brow = (j0 >> 7) * 256 + (j0 & 127) + 16 * (i & 1) + fr + (i >> 1) * 128;
            pb[i] = Bt + (size_t)brow * D + 8 * fq; }
        f32x4 acc[4][4];
        wave_gemm64(pa, pb, D, acc);
#pragma unroll
        for (int i = 0; i < 4; ++i)
#pragma unroll
            for (int j = 0; j < 2; ++j) {
                const f32x4 a = acc[i][j], b3 = acc[i][j + 2];
                const size_t hr = (size_t)(tile * 256 + (sub & 3) * 64 + 16 * i + fr);
                v2u o; o.x = pk2(silu_f(a.x) * b3.x, silu_f(a.y) * b3.y); o.y = pk2(silu_f(a.z) * b3.z, silu_f(a.w) * b3.w);
                *(v2u*)(((bf16*)(A.ws + WS_HMID)) + hr * DE + j0 + 16 * j + 4 * fq) = o;
            }
    }
}
template <int L>
__device__ __forceinline__ void p_moe2(Frame& F, const Args& A) {
    LAS int* tab = (LAS int*)F.lds; moe_table(F, A, L, tab);
    const int fr = F.lane & 15, fq = F.lane >> 4, nsub = tab[16] * 4;
    for (int it = F.gw; it < nsub * 32; it += F.NGW) {
        const int sub = it >> 5, nt = it & 31, tile = sub >> 2;
        int e = 0;
#pragma unroll
        for (int q = 1; q < 16; ++q) e = (tile >= tab[q]) ? q : e;
        const int cn = tab[32 + e], slot0 = (tile - tab[e]) * 256 + (sub & 3) * 64, n0 = nt * 64;
        const bf16* Bt = ((bf16*)(A.ws + WS_WT_MOE2)) + (size_t)(L * 16 + e) * 2048 * 1024;
        const bf16* pa[4]; const bf16* pb[4];
#pragma unroll
        for (int i = 0; i < 4; ++i) { pa[i] = ((bf16*)(A.ws + WS_HMID)) + (size_t)(tile * 256 + (sub & 3) * 64 + 16 * i + fr) * DE + 8 * fq; pb[i] = Bt + (size_t)(n0 + 16 * i + fr) * DE + 8 * fq; }
        f32x4 acc[4][4];
        wave_gemm64(pa, pb, DE, acc);
#pragma unroll
        for (int i = 0; i < 4; ++i) {
            const int slot = slot0 + 16 * i + fr;
            if (slot < cn) {
                const int ent = ((int*)(A.ws + WS_LIST))[(size_t)e * T + slot]; const float w = ((float*)(A.ws + WS_LW))[(size_t)e * T + slot];
                bf16* yo = ((bf16*)(A.ws + WS_Y2)) + (size_t)ent * D + n0 + 4 * fq;
#pragma unroll
                for (int j = 0; j < 4; ++j) { const f32x4 v = acc[i][j] * w; v2u o; o.x = pk2(v.x, v.y); o.y = pk2(v.z, v.w); *(v2u*)(yo + 16 * j) = o; }
            }
        }
    }
}

template <int L>
__device__ __forceinline__ void p_ln2(Frame& F, const Args& A) {
    constexpr int NR = L == 0 ? T : NLAT;
    const float* lg = (A.in[6]) + (size_t)(L * 2 + 1) * D; const float* lb = (A.in[7]) + (size_t)(L * 2 + 1) * D;
    for (int row = F.gw; row < NR; row += F.NGW) {
        int l4 = F.lane * 4; asm volatile("" : "+v"(l4));
        const int r = row < NLAT ? (row >> 12) : 4;
        const float* hin = ((float*)(A.ws + WS_H)) + (size_t)row * D;
        const float* mp = ((float*)(A.ws + WS_MOD)) + (size_t)(L * 5 + r) * MODW;
        const bf16* y2 = ((bf16*)(A.ws + WS_Y2)) + (size_t)row * 2 * D;
        f32x4 v[8]; float sm = 0.f;
#pragma unroll
        for (int j = 0; j < 8; ++j) { const int col = j * 256 + l4;
            const v2u ya = *(const v2u*)(y2 + col), yb = *(const v2u*)(y2 + D + col);
            const f32x4 yy = (f32x4){bflo(ya.x) + bflo(yb.x), bfhi(ya.x) + bfhi(yb.x), bflo(ya.y) + bflo(yb.y), bfhi(ya.y) + bfhi(yb.y)};
            v[j] = ALPHA * *(const f32x4*)(hin + col) + *(const f32x4*)(mp + 5 * D + col) * yy;
            sm += (v[j].x + v[j].y) + (v[j].z + v[j].w); }
        const float mean = wave_sum(sm) * (1.f / D); float sq = 0.f;
#pragma unroll
        for (int j = 0; j < 8; ++j) { v[j] = v[j] - mean; sq += (v[j].x * v[j].x + v[j].y * v[j].y) + (v[j].z * v[j].z + v[j].w * v[j].w); }
        const float rstd = 1.f / sqrtf(wave_sum(sq) * (1.f / D) + LN_EPS);
        const float* mp1 = ((float*)(A.ws + WS_MOD)) + (size_t)(1 * 5 + r) * MODW;
#pragma unroll
        for (int j = 0; j < 8; ++j) { const int col = j * 256 + l4;
            const f32x4 hn = v[j] * rstd * *(const f32x4*)(lg + col) + *(const f32x4*)(lb + col);
            if (L == 0) {
                *(f32x4*)(((float*)(A.ws + WS_H)) + (size_t)row * D + col) = hn;
                const f32x4 a = hn * (1.f + *(const f32x4*)(mp1 + D + col)) + *(const f32x4*)(mp1 + col);
                v2u o; o.x = pk2(a.x, a.y); o.y = pk2(a.z, a.w); *(v2u*)(((bf16*)(A.ws + WS_AF)) + (size_t)row * D + col) = o;
            } else *(f32x4*)((A.out) + (size_t)row * D + col) = hn;
        }
    }
}

__device__ __forceinline__ void p_nat_attn(Frame& F, const Args& A) {
    LAS float* qsh = (LAS float*)F.lds + F.wave * 1024;
    LAS float* psh = qsh + 128; LAS int* rsh = (LAS int*)(qsh + 512);
    const float scale = 0.08838834764831845f;
    for (int it = F.gw; it < NLAT * NAT_H; it += F.NGW) {
        const int row = it >> 4, h = it & 15, b = row >> 12, n = row & 4095, qi = n >> 6, qj = n & 63;
        const int rs = min(max(qi - 4, 0), 56), cs = min(max(qj - 8, 0), 48);
        { const unsigned w = *(const unsigned*)(((bf16*)(A.ws + WS_P)) + (size_t)row * NAT_IN + h * 128 + 2 * F.lane); qsh[2 * F.lane] = bflo(w) * scale; qsh[2 * F.lane + 1] = bfhi(w) * scale; }
        asm volatile("s_waitcnt lgkmcnt(0)" ::: "memory");
#pragma unroll 1
        for (int i = 0; i < 6; ++i) {
            const int kk = F.lane + 64 * i; int krow; float bias = 0.f;
            if (kk < 128) { const int r = rs + (kk >> 4), cc = cs + (kk & 15); krow = b * SEQ + r * 64 + cc; bias = (A.in[14])[h * 465 + (r - qi + 7) * 31 + (cc - qj + 15)]; }
            else krow = NLAT + b * CTXL + (kk - 128);
            const v4u* kp = (const v4u*)(((bf16*)(A.ws + WS_P)) + (size_t)krow * NAT_IN + 2048 + h * 128);
            float s = 0.f;
#pragma unroll
            for (int c8 = 0; c8 < 16; ++c8) { const v4u kv = kp[c8]; const LAS f32x4* qq = (const LAS f32x4*)(qsh + 8 * c8); const f32x4 q0 = qq[0], q1 = qq[1];
                s += bflo(kv.x) * q0.x + bfhi(kv.x) * q0.y + bflo(kv.y) * q0.z + bfhi(kv.y) * q0.w + bflo(kv.z) * q1.x + bfhi(kv.z) * q1.y + bflo(kv.w) * q1.z + bfhi(kv.w) * q1.w; }
            psh[kk] = s + bias; rsh[kk] = krow;
        }
        asm volatile("s_waitcnt lgkmcnt(0)" ::: "memory");
        float sc[6];
#pragma unroll
        for (int i = 0; i < 6; ++i) sc[i] = psh[F.lane + 64 * i];
        float m = sc[0];
#pragma unroll
        for (int i = 1; i < 6; ++i) m = fmaxf(m, sc[i]);
        m = wave_max(m);
        float l = 0.f;
#pragma unroll
        for (int i = 0; i < 6; ++i) { sc[i] = __expf(sc[i] - m); l += sc[i]; psh[F.lane + 64 * i] = sc[i]; }
        l = wave_sum(l);
        asm volatile("s_waitcnt lgkmcnt(0)" ::: "memory");
        float o0 = 0.f, o1 = 0.f;
#pragma unroll 4
        for (int kk = 0; kk < 384; ++kk) {
            const float p = psh[kk]; const int krow = rsh[kk];
            const unsigned w = *(const unsigned*)(((bf16*)(A.ws + WS_P)) + (size_t)krow * NAT_IN + 4096 + h * 128 + 2 * F.lane);
            o0 += p * bflo(w); o1 += p * bfhi(w);
        }
        const float il = 1.f / l;
        *(unsigned*)(((bf16*)(A.ws + WS_AF)) + (size_t)row * D + h * 128 + 2 * F.lane) = pk2(o0 * il, o1 * il);
        asm volatile("s_waitcnt lgkmcnt(0)" ::: "memory");
    }
}

constexpr int NPHASE = 18;

__global__ void __launch_bounds__(NTHR, 2) mk_fwd(Args args) {
    extern __shared__ __attribute__((aligned(16))) unsigned char lds[];
    Frame F;
    F.lds = (LAS unsigned char*)lds;
    F.MISC = (volatile LAS unsigned*)(F.lds + MISC_OFF);
    F.tid = threadIdx.x; F.lane = F.tid & 63; F.wave = __builtin_amdgcn_readfirstlane(F.tid >> 6);
    F.G = gridDim.x; F.gw = blockIdx.x * NWAVES + F.wave; F.NGW = F.G * NWAVES;
    unsigned* ctl = (unsigned*)(args.ws + WS_CTL);

    for (int u = F.tid; u < 64; u += NTHR) ((LAS unsigned*)(F.lds + MISC_OFF))[u] = 0u;
    __syncthreads();
    XcdBarrier bar; bar.bar = ctl + CW_BAR; bar.x = 0; bar.st = nullptr;
    if (!MK_MULTI) bar = xcd_barrier_post(ctl + CW_BAR, F.MISC + 8);
    const int lo = args.ph_lo, hi = args.ph_hi;
#ifndef PH_MASK
#define PH_MASK 0xFFFFFFFFu
#endif
#define IN(k) (((PH_MASK >> (k)) & 1u) && lo <= (k) && (k) < hi)
#define SEAM(k) do { if (IN(k) && IN((k) + 1)) xcd_barrier(bar); } while (0)

    if (IN(0)) { p_ada(F, args); p_transposes(F, args); } SEAM(0);
    if (IN(1)) { p_modulate0(F, args); } SEAM(1);
    if (IN(2)) { p_gemm_gla_in(F, args); } SEAM(2);
    if (IN(3)) { p_gla_prep(F, args); } SEAM(3);
    if (IN(4)) { p_gla_scan(F, args); } SEAM(4);
    if (IN(5)) { p_gla_finish(F, args); } SEAM(5);
    if (IN(6)) { p_gemm_plain<false>(F, args, (const bf16*)(args.ws + WS_AF), (const bf16*)(args.ws + WS_WT_GLA_OUT), T, D, D, args.ws + WS_Y, D); } SEAM(6);
    if (IN(7)) { p_ln1<0>(F, args); } SEAM(7);
    if (IN(8)) { p_moe1<0>(F, args); } SEAM(8);
    if (IN(9)) { p_moe2<0>(F, args); } SEAM(9);
    if (IN(10)) { p_ln2<0>(F, args); } SEAM(10);
    if (IN(11)) { p_gemm_plain<true>(F, args, (const bf16*)(args.ws + WS_AF), (const bf16*)(args.ws + WS_WT_NAT_IN), T, NAT_IN, D, args.ws + WS_P, NAT_IN); } SEAM(11);
    if (IN(12)) { p_nat_attn(F, args); } SEAM(12);
    if (IN(13)) { p_gemm_plain<false>(F, args, (const bf16*)(args.ws + WS_AF), (const bf16*)(args.ws + WS_WT_NAT_OUT), NLAT, D, D, args.ws + WS_Y, D); } SEAM(13);
    if (IN(14)) { p_ln1<1>(F, args); } SEAM(14);
    if (IN(15)) { p_moe1<1>(F, args); } SEAM(15);
    if (IN(16)) { p_moe2<1>(F, args); } SEAM(16);
    if (IN(17)) { p_ln2<1>(F, args); }
#undef IN
#undef SEAM
}

extern "C" void kernel_launch(void* const* d_in, const int* in_sizes, int n_in, void* d_out, int out_size, void* d_ws, size_t ws_size, hipStream_t stream) {
    static int grid = 0;
    if (grid == 0) {
        if (n_in != 23 || ws_size < WS_END) { fprintf(stderr, "kernel_launch: expected 23 inputs and >= %zu bytes of workspace; got %d, %zu\n", (size_t)WS_END, n_in, ws_size); grid = -1; return; }
        int dev = 0, cus = 0, per_cu = 0;
        if (hipGetDevice(&dev) != hipSuccess || hipDeviceGetAttribute(&cus, hipDeviceAttributeMultiprocessorCount, dev) != hipSuccess) { grid = -1; return; }
        if (hipFuncSetAttribute((const void*)mk_fwd, hipFuncAttributeMaxDynamicSharedMemorySize, LDS_BYTES) != hipSuccess) { fprintf(stderr, "kernel_launch: hipFuncSetAttribute failed\n"); grid = -1; return; }
        if (hipOccupancyMaxActiveBlocksPerMultiprocessor(&per_cu, (const void*)mk_fwd, NTHR, LDS_BYTES) != hipSuccess || per_cu < 1) fprintf(stderr, "kernel_launch: occupancy query reports %d\n", per_cu);
        (void)hipGetLastError();
        grid = cus;
    }
    if (grid < 0) return;
    (void)hipMemsetAsync((char*)d_ws + WS_CTL, 0, CTL_ZERO_BYTES, stream);
    Args a{};
    for (int i = 0; i < 23; ++i) a.in[i] = (const float*)d_in[i];
    a.out = (float*)d_out; a.ws = (unsigned char*)d_ws;
#if MK_MULTI
    for (int p = 0; p < NPHASE; ++p) { a.ph_lo = p; a.ph_hi = p + 1; hipLaunchKernelGGL(mk_fwd, dim3(grid), dim3(NTHR), LDS_BYTES, stream, a); }
#else
    a.ph_lo = 0; a.ph_hi = NPHASE;
    hipLaunchKernelGGL(mk_fwd, dim3(grid), dim3(NTHR), LDS_BYTES, stream, a);
#endif
}
```
